# Optimizing an MI355X kernel written in HIP

```python
import jax, jax.numpy as jnp
from jax import lax
import numpy as np

D_MODEL = 1024
BATCH = 16
SEQ = 2048
DEPTH = 1

HEAD_DIM = 64
HEADS_PER_GROUP = 4
DILATED_GROUPS = ((128, 1), (512, 4), (2048, 16))
N_GROUPS = 3
N_ATTN_HEADS = N_GROUPS * HEADS_PER_GROUP
ATTN_WIDTH = N_ATTN_HEADS * HEAD_DIM
ATTN_OUT_WIDTH = HEADS_PER_GROUP * HEAD_DIM
CONV_WIDTH = D_MODEL
CONV_K = 3
SUB_BLOCK = 128
ALIBI_MAX_EXP = 8.0
DEEPNORM_ALPHA = (2.0 * DEPTH) ** 0.25
DEEPNORM_BETA = (8.0 * DEPTH) ** -0.25
LN_EPS = 1e-5
IN_WIDTHS = (ATTN_WIDTH, ATTN_WIDTH, ATTN_WIDTH, ATTN_OUT_WIDTH,
             CONV_WIDTH, CONV_WIDTH, CONV_WIDTH, CONV_WIDTH, D_MODEL, D_MODEL)
D_IN = 3 * ATTN_WIDTH + ATTN_OUT_WIDTH + 4 * CONV_WIDTH + 2 * D_MODEL

kernel_name = "hybrid_dilated_attn_shortconv_deepnorm_adaln"


def _split_points():
    pts, acc = [], 0
    for w in IN_WIDTHS[:-1]:
        acc += w
        pts.append(acc)
    return pts


def _layer_norm(x, g, b):
    xf = x.astype(jnp.float32)
    mu = xf.mean(-1, keepdims=True)
    var = jnp.square(xf - mu).mean(-1, keepdims=True)
    y = (xf - mu) * lax.rsqrt(var + LN_EPS) * g.astype(jnp.float32) + b.astype(jnp.float32)
    return y.astype(x.dtype)


def _dilated_window_attention(q, k, v, window, dilation, slopes):
    bsz, s, h, dh = q.shape
    span = window // dilation
    n = s // dilation
    L = SUB_BLOCK
    nb = -(-n // L)
    pad = nb * L - n

    def to_sub(t):
        t = t.reshape(bsz, n, dilation, h, dh).transpose(0, 2, 1, 3, 4)
        t = jnp.pad(t, ((0, 0), (0, 0), (0, pad), (0, 0), (0, 0)))
        return t.reshape(bsz, dilation, nb, L, h, dh)

    def with_prev(t):
        prev = jnp.pad(t, ((0, 0), (0, 0), (1, 0), (0, 0), (0, 0), (0, 0)))[:, :, :-1]
        return jnp.concatenate([prev, t], axis=3)

    qs = to_sub(q)
    kb = with_prev(to_sub(k))
    vb = with_prev(to_sub(v))

    scores = jnp.einsum('brnqhd,brnkhd->brnhqk', qs, kb).astype(jnp.float32) * (dh ** -0.5)
    qi = jnp.arange(L)[:, None]
    kj = jnp.arange(2 * L)[None, :]
    delta = qi + L - kj
    key_sub = jnp.arange(nb)[:, None, None] * L + kj[None] - L
    valid = (delta >= 0) & (delta <= span) & (key_sub >= 0)
    alibi = -slopes[:, None, None] * (delta * dilation).astype(jnp.float32)[None]
    scores = scores + alibi[None, None, None]
    scores = jnp.where(valid[None, None, :, None], scores, -jnp.inf)
    m = scores.max(-1, keepdims=True)
    p = jnp.exp(scores - m)
    den = p.sum(-1, keepdims=True)
    out = jnp.einsum('brnhqk,brnkhd->brnqhd', (p / den).astype(v.dtype), vb)
    lse = jnp.swapaxes((m + jnp.log(den))[..., 0], 3, 4)

    def from_sub(t):
        t = t.reshape((bsz, dilation, nb * L) + t.shape[4:])[:, :, :n]
        return jnp.swapaxes(t, 1, 2).reshape((bsz, s) + t.shape[3:])

    return from_sub(out), from_sub(lse)


def setup_inputs(seed: int = 0) -> dict:
    key = jax.random.key(seed)
    ks = jax.random.split(key, 16)
    f32 = jnp.float32
    x = jax.random.normal(ks[0], (BATCH, SEQ, D_MODEL), f32)
    c = jax.random.normal(ks[1], (BATCH, D_MODEL), f32)
    w_ada = jax.random.normal(ks[2], (DEPTH, D_MODEL, 3 * D_MODEL), f32) * (D_MODEL ** -0.5) * 0.5
    b_ada = jax.random.normal(ks[3], (DEPTH, 3 * D_MODEL), f32) * 0.01
    w_in = jax.random.normal(ks[4], (DEPTH, D_MODEL, D_IN), f32) * (D_MODEL ** -0.5)
    w_in = w_in.at[:, :, 2 * ATTN_WIDTH:3 * ATTN_WIDTH].multiply(DEEPNORM_BETA)
    b_in = jax.random.normal(ks[5], (DEPTH, D_IN), f32) * 0.01
    conv_w = jax.random.normal(ks[6], (DEPTH, CONV_K, CONV_WIDTH), f32) * (CONV_K ** -0.5)
    w_proj_attn = jax.random.normal(ks[7], (DEPTH, ATTN_OUT_WIDTH, D_MODEL), f32) * (ATTN_OUT_WIDTH ** -0.5) * DEEPNORM_BETA
    w_proj_conv = jax.random.normal(ks[8], (DEPTH, CONV_WIDTH, D_MODEL), f32) * (CONV_WIDTH ** -0.5) * DEEPNORM_BETA
    w_out = jax.random.normal(ks[9], (DEPTH, D_MODEL, D_MODEL), f32) * (D_MODEL ** -0.5) * DEEPNORM_BETA
    b_out = jax.random.normal(ks[10], (DEPTH, D_MODEL), f32) * 0.01
    ln_g = 1.0 + 0.02 * jax.random.normal(ks[11], (DEPTH, D_MODEL), f32)
    ln_b = 0.02 * jax.random.normal(ks[12], (DEPTH, D_MODEL), f32)
    return {"x": x, "c": c, "w_ada": w_ada, "b_ada": b_ada, "w_in": w_in, "b_in": b_in,
            "conv_w": conv_w, "w_proj_attn": w_proj_attn, "w_proj_conv": w_proj_conv,
            "w_out": w_out, "b_out": b_out, "ln_g": ln_g, "ln_b": ln_b}


def reference(x, c, w_ada, b_ada, w_in, b_in, conv_w, w_proj_attn, w_proj_conv, w_out, b_out, ln_g, ln_b):
    bsz, s, _ = x.shape
    split_pts = _split_points()
    slopes = 2.0 ** (-ALIBI_MAX_EXP * (jnp.arange(N_ATTN_HEADS, dtype=jnp.float32) + 1.0) / N_ATTN_HEADS)
    c_act = jax.nn.silu(c)
    for layer in range(DEPTH):
        ada = (c_act @ w_ada[layer] + b_ada[layer])[:, None, :]
        shift, scale, gate = jnp.split(ada, 3, axis=-1)
        h = x * (1.0 + scale) + shift

        proj = h @ w_in[layer] + b_in[layer]
        q, k, v, z_attn, u_x, g_b, g_c, z_conv, g_mix_a, g_mix_b = jnp.split(proj, split_pts, axis=-1)
        q = q.reshape(bsz, s, N_ATTN_HEADS, HEAD_DIM)
        k = k.reshape(bsz, s, N_ATTN_HEADS, HEAD_DIM)
        v = v.reshape(bsz, s, N_ATTN_HEADS, HEAD_DIM)

        outs, lses = [], []
        for g, (window, dilation) in enumerate(DILATED_GROUPS):
            hs = slice(g * HEADS_PER_GROUP, (g + 1) * HEADS_PER_GROUP)
            o_g, lse_g = _dilated_window_attention(q[:, :, hs], k[:, :, hs], v[:, :, hs],
                                                   window, dilation, slopes[hs])
            outs.append(o_g.astype(jnp.float32))
            lses.append(lse_g)
        mix_w = jax.nn.softmax(jnp.stack(lses), axis=0)
        o_attn = jnp.einsum('gbsh,gbshd->bshd', mix_w, jnp.stack(outs)).astype(x.dtype)
        o_attn = o_attn.reshape(bsz, s, ATTN_OUT_WIDTH)
        y_attn = (o_attn * jax.nn.silu(z_attn)) @ w_proj_attn[layer]

        u = g_c * u_x
        u_pad = jnp.pad(u, ((0, 0), (CONV_K - 1, 0), (0, 0)))
        cw = conv_w[layer]
        conv = cw[0] * u_pad[:, 0:s]
        for j in range(1, CONV_K):
            conv = conv + cw[j] * u_pad[:, j:j + s]
        y_conv = (g_b * conv * jax.nn.silu(z_conv)) @ w_proj_conv[layer]

        merged = jax.nn.sigmoid(g_mix_a) * y_attn + jax.nn.sigmoid(g_mix_b) * y_conv
        sub = gate * (merged @ w_out[layer] + b_out[layer])
        x = _layer_norm(DEEPNORM_ALPHA * x + sub, ln_g[layer], ln_b[layer])
    return x
```

```cpp
#include <hip/hip_runtime.h>
#include <hip/hip_cooperative_groups.h>
#include <cstdio>
#include <cstdint>
namespace cg = cooperative_groups;
namespace pg8 {
#define PG8_LAS __attribute__((address_space(3)))
typedef unsigned short bf16_t;
typedef short bf16x8 __attribute__((ext_vector_type(8)));
typedef float f32x4 __attribute__((ext_vector_type(4)));
typedef unsigned u32x4 __attribute__((ext_vector_type(4)));
constexpr int BM = 256, BK = 64, HALF = 128, HTB = HALF * BK * 2  , STAGE_BYTES = 8 * HTB, NXCD = 8, WGM = 8;

__host__ __device__ __forceinline__ int lds_byte(int r, int c) { const int st = (r >> 4) * 2 + (c >> 5), rr = r & 15, cc = c & 31, ob = rr * 64 + cc * 2; return st * 1024 + (ob ^ (((ob >> 9) & 1) << 5)); }
__host__ __device__ __forceinline__ void stage_rc(int b, int& R, int& C) { const int st = b / 1024, sb = b % 1024, swz = sb ^ (((sb >> 9) & 1) << 5); R = (st >> 1) * 16 + swz / 64; C = (st & 1) * 32 + (swz % 64) / 2; }
__host__ __device__ __forceinline__ int perm32(int rho) { const int n = rho >> 4, i = rho & 15; return 8 * (i >> 2) + 4 * n + (i & 3); }

struct Unit { int pm, pn; };
struct Gemm { const bf16_t* A; const bf16_t* Bt; int M, N, K; };

struct StaticOrder {
    int nM, nN, nwg, G, c;
    __host__ __device__ void init(int M, int N, int G_, int c_) { nM = M / BM; nN = N / BM; nwg = nM * nN; G = G_; c = c_; }
    __host__ __device__ bool next(int i, Unit& u) const {
        const long L = (long)i * G + c; if (L >= nwg) return false;
        int wgid = (int)L; { const int q = nwg / NXCD, r = nwg % NXCD, xcd = wgid % NXCD, off = wgid / NXCD; wgid = (xcd < r ? xcd * (q + 1) : r * (q + 1) + (xcd - r) * q) + off; }
        const int nig = WGM * nN, gid = wgid / nig, fm = gid * WGM, gsz = (nM - fm) < WGM ? (nM - fm) : WGM;
        u.pm = fm + ((wgid % nig) % gsz); u.pn = (wgid % nig) / gsz; return true;
    }
    __device__ __forceinline__ void a_ready(const Unit&) const {}
    __device__ __forceinline__ void done(const Unit&) const {}
};

typedef __bf16 bf16x2_t __attribute__((ext_vector_type(2)));
typedef float f32x2_t __attribute__((ext_vector_type(2)));
__device__ __forceinline__ unsigned cvt_pk_bf16(float lo, float hi) { f32x2_t v = {lo, hi}; bf16x2_t r = __builtin_convertvector(v, bf16x2_t); return __builtin_bit_cast(unsigned, r); }
typedef float f32x2 __attribute__((ext_vector_type(2)));
template <class Epi, class Sched, bool ALIGN_EPI = false, bool SP2 = false>
__device__ __forceinline__ void gemm_phase(PG8_LAS unsigned char* lds, const Gemm g, const Sched& S, const Epi& E) {
    const int tid = threadIdx.x, wid = __builtin_amdgcn_readfirstlane(tid >> 6), lane = tid & 63, wr = wid >> 2, wc = wid & 3, fr = lane & 15, fq = lane >> 4;
    const int K = g.K, nt = K / BK;
    unsigned voffA[2], voffB[2];
#pragma unroll
    for (int i = 0; i < 2; ++i) { int R, C; stage_rc(tid * 16 + i * 8192, R, C); const int Rb = Epi::PERM ? ((R & ~31) + perm32(R & 31)) : R;
        voffA[i] = (unsigned)(R * K + C) * 2u; voffB[i] = (unsigned)(Rb * K + C) * 2u; }
    const size_t kstep = (size_t)(BK * 2);
    const size_t hstep = (size_t)HALF * K * 2;
    const size_t tstep = 2 * hstep;
    const unsigned ldsw = (unsigned)wid * 1024u;
    const int aoff = lds_byte(wr * 64 + fr, fq * 8), boff = lds_byte(wc * 32 + fr, fq * 8);
#define PG8_SA(b, h) (((b) * 2 + (h)) * HTB)
#define PG8_SB(b, h) ((4 + (b) * 2 + (h)) * HTB)
#define PG8_STAGE(bufoff, gbase, voff) do { _Pragma("unroll") for (int _i = 0; _i < 2; ++_i) \
        __builtin_amdgcn_global_load_lds((const unsigned*)((const char*)(gbase) + (voff)[_i]), (PG8_LAS unsigned*)(lds + (bufoff) + ldsw + _i * 8192), 16, 0, 0); } while (0)
#define PG8_LDA(dst, b, h) do { _Pragma("unroll") for (int m = 0; m < 4; ++m) _Pragma("unroll") for (int k = 0; k < 2; ++k) dst[m][k] = *(const PG8_LAS bf16x8*)(lds + PG8_SA(b, h) + aoff + m * 2048 + k * 1024); } while (0)
#define PG8_LDB(dst, b, h) do { _Pragma("unroll") for (int n = 0; n < 2; ++n) _Pragma("unroll") for (int k = 0; k < 2; ++k) dst[n][k] = *(const PG8_LAS bf16x8*)(lds + PG8_SB(b, h) + boff + n * 2048 + k * 1024); } while (0)
#define PG8_MMA(ai, bj, At, Bt) do { __builtin_amdgcn_s_setprio(1); _Pragma("unroll") for (int m = 0; m < 4; ++m) _Pragma("unroll") for (int n = 0; n < 2; ++n) _Pragma("unroll") for (int k = 0; k < 2; ++k) \
        acc[ai][bj][m][n] = __builtin_amdgcn_mfma_f32_16x16x32_bf16(Bt[n][k], At[m][k], acc[ai][bj][m][n], 0, 0, 0); __builtin_amdgcn_s_setprio(0); } while (0)
#define PG8_WAIT_V(n) asm volatile("s_waitcnt vmcnt(" #n ")" ::: "memory")
#define PG8_WAIT_L(n) asm volatile("s_waitcnt lgkmcnt(" #n ")" ::: "memory")
#define PG8_BAR __builtin_amdgcn_s_barrier()
#define PG8_SCHED __builtin_amdgcn_sched_barrier(0)
    Unit cur, nxt; int ui = 0;
    if (!S.next(0, cur)) return;
    f32x4 acc[2][2][4][2];
#pragma unroll
    for (int a = 0; a < 2; ++a)
#pragma unroll
        for (int b = 0; b < 2; ++b)
#pragma unroll
            for (int m = 0; m < 4; ++m)
#pragma unroll
                for (int n = 0; n < 2; ++n) acc[a][b][m][n] = (f32x4){0.f, 0.f, 0.f, 0.f};
    bf16x8 At[4][2], B0[2][2], B1[2][2];
    const char* cA = (const char*)g.A + (size_t)cur.pm * tstep; const char* cB = (const char*)g.Bt + (size_t)cur.pn * tstep;
    S.a_ready(cur);
    if constexpr (SP2) {
        PG8_STAGE(PG8_SB(0, 0), cB, voffB); PG8_STAGE(PG8_SB(0, 1), cB + hstep, voffB); PG8_STAGE(PG8_SA(0, 0), cA, voffA); PG8_STAGE(PG8_SA(0, 1), cA + hstep, voffA);
        if (wr == 1) PG8_BAR;
        PG8_WAIT_V(2); PG8_BAR;
        PG8_STAGE(PG8_SB(1, 0), cB + kstep, voffB); PG8_STAGE(PG8_SA(1, 0), cA + kstep, voffA); PG8_STAGE(PG8_SB(1, 1), cB + hstep + kstep, voffB);
        PG8_WAIT_V(6); PG8_BAR;
    } else {
        PG8_STAGE(PG8_SB(0, 0), cB, voffB); PG8_STAGE(PG8_SA(0, 0), cA, voffA); PG8_STAGE(PG8_SB(0, 1), cB + hstep, voffB); PG8_STAGE(PG8_SA(0, 1), cA + hstep, voffA);
        if (wr == 1) PG8_BAR;
        PG8_WAIT_V(4); PG8_BAR;
        PG8_STAGE(PG8_SB(1, 0), cB + kstep, voffB); PG8_STAGE(PG8_SA(1, 0), cA + kstep, voffA); PG8_STAGE(PG8_SB(1, 1), cB + hstep + kstep, voffB);
        PG8_WAIT_V(6); PG8_BAR;
    }
    for (;;) {
        const bool has_next = S.next(ui + 1, nxt);
        const char* nA = has_next ? (const char*)g.A + (size_t)nxt.pm * tstep : cA; const char* nB = has_next ? (const char*)g.Bt + (size_t)nxt.pn * tstep : cB;
        for (int t = 0; t < nt; t += 2) {
            const bool last = (t == nt - 2);
            const char* a1 = cA + (size_t)(t + 1) * kstep;
            const char* a2 = last ? nA : cA + (size_t)(t + 2) * kstep; const char* b2 = last ? nB : cB + (size_t)(t + 2) * kstep;
            const char* a3 = a2 + kstep; const char* b3 = b2 + kstep;
            if (last && has_next) S.a_ready(nxt);
            if constexpr (SP2) {
            PG8_LDB(B0, 0, 0); PG8_LDB(B1, 0, 1); PG8_SCHED; PG8_LDA(At, 0, 0); PG8_STAGE(PG8_SA(1, 1), a1 + hstep, voffA);
            PG8_WAIT_V(8); PG8_WAIT_L(0); PG8_BAR; PG8_MMA(0, 0, At, B0); PG8_MMA(0, 1, At, B1); PG8_BAR; PG8_SCHED;
            PG8_LDA(At, 0, 1); PG8_STAGE(PG8_SB(0, 0), b2, voffB); PG8_STAGE(PG8_SB(0, 1), b2 + hstep, voffB); PG8_STAGE(PG8_SA(0, 0), a2, voffA);
            PG8_WAIT_V(8); PG8_WAIT_L(0); PG8_BAR; PG8_MMA(1, 0, At, B0); PG8_MMA(1, 1, At, B1); PG8_BAR; PG8_SCHED;
            PG8_LDB(B0, 1, 0); PG8_LDB(B1, 1, 1); PG8_SCHED; PG8_LDA(At, 1, 0); PG8_STAGE(PG8_SA(0, 1), a2 + hstep, voffA);
            PG8_WAIT_V(8); PG8_WAIT_L(0); PG8_BAR; PG8_MMA(0, 0, At, B0); PG8_MMA(0, 1, At, B1); PG8_BAR; PG8_SCHED;
            PG8_LDA(At, 1, 1); PG8_STAGE(PG8_SB(1, 0), b3, voffB); PG8_STAGE(PG8_SB(1, 1), b3 + hstep, voffB); PG8_STAGE(PG8_SA(1, 0), a3, voffA);
            PG8_WAIT_V(8); PG8_WAIT_L(0); PG8_BAR; PG8_MMA(1, 0, At, B0); PG8_MMA(1, 1, At, B1); PG8_BAR; PG8_SCHED;
            } else {
            PG8_LDB(B0, 0, 0); PG8_SCHED; PG8_LDA(At, 0, 0); PG8_STAGE(PG8_SA(1, 1), a1 + hstep, voffA);
            PG8_WAIT_L(8); PG8_BAR; PG8_WAIT_L(0); PG8_MMA(0, 0, At, B0); PG8_BAR; PG8_SCHED;
            PG8_LDB(B1, 0, 1); PG8_STAGE(PG8_SB(0, 0), b2, voffB);
            PG8_BAR; PG8_WAIT_L(0); PG8_MMA(0, 1, At, B1); PG8_BAR;
            PG8_LDA(At, 0, 1); PG8_STAGE(PG8_SA(0, 0), a2, voffA);
            PG8_BAR; PG8_WAIT_L(0); PG8_MMA(1, 0, At, B0); PG8_BAR; PG8_SCHED;
            PG8_STAGE(PG8_SB(0, 1), b2 + hstep, voffB);
            PG8_WAIT_V(6); PG8_BAR; PG8_MMA(1, 1, At, B1); PG8_BAR;
            PG8_LDB(B0, 1, 0); PG8_SCHED; PG8_LDA(At, 1, 0); PG8_STAGE(PG8_SA(0, 1), a2 + hstep, voffA);
            PG8_WAIT_L(8); PG8_BAR; PG8_WAIT_L(0); PG8_MMA(0, 0, At, B0); PG8_BAR; PG8_SCHED;
            PG8_LDB(B1, 1, 1); PG8_STAGE(PG8_SB(1, 0), b3, voffB);
            PG8_BAR; PG8_WAIT_L(0); PG8_MMA(0, 1, At, B1); PG8_BAR;
            PG8_LDA(At, 1, 1); PG8_STAGE(PG8_SA(1, 0), a3, voffA);
            PG8_BAR; PG8_WAIT_L(0); PG8_MMA(1, 0, At, B0); PG8_BAR; PG8_SCHED;
            PG8_STAGE(PG8_SB(1, 1), b3 + hstep, voffB);
            PG8_WAIT_V(6); PG8_BAR; PG8_MMA(1, 1, At, B1); PG8_BAR;
            }
        }
        if constexpr (ALIGN_EPI) { if (wr == 0) PG8_BAR; }
        if constexpr (!Epi::AFTER_DRAIN) { E(acc, cur, wr, wc, fr, fq); S.done(cur); }
        if (!has_next) break;
#pragma unroll
        for (int a = 0; a < 2; ++a)
#pragma unroll
            for (int b = 0; b < 2; ++b)
#pragma unroll
                for (int m = 0; m < 4; ++m)
#pragma unroll
                    for (int n = 0; n < 2; ++n) acc[a][b][m][n] = (f32x4){0.f, 0.f, 0.f, 0.f};
        cur = nxt; cA = nA; cB = nB; ++ui;
        if constexpr (ALIGN_EPI) { if (wr == 1) PG8_BAR; }
    }
    PG8_WAIT_V(0);
    if constexpr (!ALIGN_EPI) { if (wr == 0) PG8_BAR; }
    PG8_BAR;
    if constexpr (Epi::AFTER_DRAIN) { E.fused(acc, cur, wr, wc, fr, fq, lds, wid, lane); S.done(cur); }
#undef PG8_SA
#undef PG8_SB
#undef PG8_STAGE
#undef PG8_LDA
#undef PG8_LDB
#undef PG8_MMA
#undef PG8_WAIT_V
#undef PG8_WAIT_L
#undef PG8_BAR
#undef PG8_SCHED
}
}

namespace mk {
using pg8::bf16_t; using pg8::f32x4; using pg8::u32x4; using pg8::bf16x8; using pg8::Unit; using pg8::cvt_pk_bf16;
typedef unsigned u32x2 __attribute__((ext_vector_type(2)));
#define LAS __attribute__((address_space(3)))

constexpr int BATCH = 16, SEQ = 2048, D = 1024, M = BATCH * SEQ, DIN = 8704, QKVW = 2304, AOW = 256;
constexpr float LOG2E = 1.4426950408889634f, LN2F = 0.6931471805599453f;
constexpr float C2 = 0.125f * LOG2E;
constexpr float ALPHA = 1.189207115002721f;
constexpr float LN_EPS = 1e-5f;
constexpr int NWAVES = 8, NTHREADS = 512;
constexpr int LDS_BYTES = 147456;

constexpr size_t MiB = 1u << 20;
constexpr size_t WS_ADA = 0;
constexpr size_t WS_BAR = 512 * 1024;
constexpr size_t WS_WIN = 1 * MiB;
constexpr size_t WS_WPA = 18 * MiB;
constexpr size_t WS_WPB = 19 * MiB;
constexpr size_t WS_WOUT = 21 * MiB;
constexpr size_t WS_H = 32 * MiB;
constexpr size_t WS_QKV = 96 * MiB;
constexpr size_t WS_U = 240 * MiB;
constexpr size_t WS_GZ = 304 * MiB;
constexpr size_t WS_GA = 368 * MiB;
constexpr size_t WS_GB = 432 * MiB;
constexpr size_t WS_END = 496 * MiB;
constexpr size_t DO_OG = 0, DO_ZA = 48 * MiB, DO_LSE = 64 * MiB;

struct Params {
    const float *x, *c, *w_ada, *b_ada, *w_in, *b_in, *conv_w, *w_pa, *w_pb, *w_out, *b_out, *ln_g, *ln_b;
    float* out; unsigned char* ws;
};

__device__ __forceinline__ float sigm(float v) { return __builtin_amdgcn_rcpf(1.f + __builtin_amdgcn_exp2f(-v * LOG2E)); }
__device__ __forceinline__ float bf_lo(unsigned u) { return __uint_as_float(u << 16); }
__device__ __forceinline__ float bf_hi(unsigned u) { return __uint_as_float(u & 0xffff0000u); }
__device__ __forceinline__ float wave_sum(float v) {
#pragma unroll
    for (int o = 1; o < 64; o <<= 1) v += __shfl_xor(v, o);
    return v;
}
#define LDS_WAIT() asm volatile("s_waitcnt lgkmcnt(0)" ::: "memory")

__host__ __device__ __forceinline__ int src_col(int p) {
    const int pn = p >> 8, q = p & 255;
    if (pn < 10 || pn >= 26) return p;
    const int bj = q >> 7, wc = (q >> 5) & 3, fq = (q >> 3) & 3, n = (q >> 2) & 1, j = q & 3;
    const int kind = 2 * bj + n, ch = 64 * (pn - 10) + 16 * wc + 4 * fq + j;
    const int base = kind == 0 ? 2560 : (kind == 1 ? 4608 : (kind == 2 ? 3584 : 5632));
    return base + ch;
}

template <bool MAP> __device__ __forceinline__ void transpose_item(const float* W, int K, int N, bf16_t* WT, LAS float* scr, int item, int lane) {
    const int nblk = N / 32, kb = item / nblk, nb = item % nblk, k0 = 64 * kb, n0 = 32 * nb;
    const int sc = MAP ? src_col(n0 + (lane & 31)) : (n0 + (lane & 31));
#pragma unroll 8
    for (int i = 0; i < 32; ++i) { const int kk = 2 * i + (lane >> 5); scr[kk * 33 + (lane & 31)] = W[(size_t)(k0 + kk) * N + sc]; }
    LDS_WAIT();
    const int c = lane & 7;
#pragma unroll
    for (int j = 0; j < 4; ++j) { const int n = (lane >> 3) + 8 * j; const LAS float* s = scr + (8 * c) * 33 + n;
        u32x4 o; o.x = cvt_pk_bf16(s[0 * 33], s[1 * 33]); o.y = cvt_pk_bf16(s[2 * 33], s[3 * 33]); o.z = cvt_pk_bf16(s[4 * 33], s[5 * 33]); o.w = cvt_pk_bf16(s[6 * 33], s[7 * 33]);
        *(u32x4*)(WT + (size_t)(n0 + n) * K + k0 + 8 * c) = o; }
    LDS_WAIT();
}

__device__ __forceinline__ void ada_block(const Params& p, LAS unsigned char* lds, int blk, int tid) {
    LAS float* cs = (LAS float*)lds;
    LAS float* red = (LAS float*)(lds + 65536);
    for (int e = tid; e < 16 * 1024; e += NTHREADS) { const int b = e >> 10, k = e & 1023; const float v = p.c[e]; cs[k * 16 + b] = v * sigm(v); }
    __syncthreads();
    const int w = tid >> 6, lane = tid & 63, n = blk * 64 + lane;
    f32x4 a0 = {0.f, 0.f, 0.f, 0.f}, a1 = a0, a2 = a0, a3 = a0;
    const float* wp = p.w_ada + (size_t)(w * 128) * 3072 + n;
#pragma unroll 8
    for (int kk = 0; kk < 128; ++kk) {
        const float wv = wp[(size_t)kk * 3072];
        const LAS f32x4* cp = (const LAS f32x4*)(cs + (w * 128 + kk) * 16);
        a0 += cp[0] * wv; a1 += cp[1] * wv; a2 += cp[2] * wv; a3 += cp[3] * wv;
    }
#pragma unroll
    for (int j = 0; j < 4; ++j) { red[(w * 16 + j) * 64 + lane] = a0[j]; red[(w * 16 + 4 + j) * 64 + lane] = a1[j]; red[(w * 16 + 8 + j) * 64 + lane] = a2[j]; red[(w * 16 + 12 + j) * 64 + lane] = a3[j]; }
    __syncthreads();
    float* ADA = (float*)(p.ws + WS_ADA);
    for (int e = tid; e < 1024; e += NTHREADS) { const int b = e >> 6, l = e & 63; float s = 0.f;
#pragma unroll
        for (int ww = 0; ww < 8; ++ww) s += red[(ww * 16 + b) * 64 + l];
        const int col = blk * 64 + l; ADA[b * 3072 + col] = s + p.b_ada[col]; }
    __syncthreads();
}

struct EpiIn {
    static constexpr bool PERM = true, AFTER_DRAIN = false;
    const float* bias; bf16_t *QKV, *ZA, *U, *GZ, *GA, *GB;
    template <int MODE> __device__ __forceinline__ void generic(const f32x4 (&acc)[2][2][4][2], bf16_t* base, int ldc, int col0, int bcol0, int row0, float sc) const {
        f32x4 bv[2][2];
#pragma unroll
        for (int bj = 0; bj < 2; ++bj)
#pragma unroll
            for (int n = 0; n < 2; ++n) bv[bj][n] = *(const f32x4*)(bias + bcol0 + bj * 128 + 4 * n);
#pragma unroll
        for (int ai = 0; ai < 2; ++ai)
#pragma unroll
            for (int m = 0; m < 4; ++m) { bf16_t* rowp = base + (size_t)(row0 + ai * 128 + m * 16) * ldc + col0;
#pragma unroll
                for (int bj = 0; bj < 2; ++bj) { f32x4 v0 = acc[ai][bj][m][0] + bv[bj][0], v1 = acc[ai][bj][m][1] + bv[bj][1];
                    if (MODE == 0) { v0 = v0 * sc; v1 = v1 * sc; }
                    else {
#pragma unroll
                        for (int j = 0; j < 4; ++j) { const float s0 = sigm(v0[j]), s1 = sigm(v1[j]); v0[j] = MODE == 1 ? v0[j] * s0 : s0; v1[j] = MODE == 1 ? v1[j] * s1 : s1; } }
                    u32x4 w; w.x = cvt_pk_bf16(v0[0], v0[1]); w.y = cvt_pk_bf16(v0[2], v0[3]); w.z = cvt_pk_bf16(v1[0], v1[1]); w.w = cvt_pk_bf16(v1[2], v1[3]);
                    *(u32x4*)(rowp + bj * 128) = w; } }
    }
    __device__ __forceinline__ void operator()(const f32x4 (&acc)[2][2][4][2], const Unit& u, int wr, int wc, int fr, int fq) const {
        const int pn = u.pn, row0 = u.pm * 256 + wr * 64 + fr, lc = wc * 32 + 8 * fq, bcol0 = pn * 256 + lc;
        if (pn < 9) generic<0>(acc, QKV, QKVW, pn * 256 + lc, bcol0, row0, pn < 3 ? C2 : 1.f);
        else if (pn == 9) generic<1>(acc, ZA, AOW, lc, bcol0, row0, 1.f);
        else if (pn >= 30) generic<2>(acc, GB, D, (pn - 30) * 256 + lc, bcol0, row0, 1.f);
        else if (pn >= 26) generic<2>(acc, GA, D, (pn - 26) * 256 + lc, bcol0, row0, 1.f);
        else {
            const int ch = 64 * (pn - 10) + 16 * wc + 4 * fq;
            const f32x4 b_ux = *(const f32x4*)(bias + 2560 + ch), b_gc = *(const f32x4*)(bias + 4608 + ch), b_gb = *(const f32x4*)(bias + 3584 + ch), b_zc = *(const f32x4*)(bias + 5632 + ch);
#pragma unroll
            for (int ai = 0; ai < 2; ++ai)
#pragma unroll
                for (int m = 0; m < 4; ++m) { const size_t off = (size_t)(row0 + ai * 128 + m * 16) * D + ch;
                    const f32x4 ux = acc[ai][0][m][0] + b_ux, gc = acc[ai][0][m][1] + b_gc, gb = acc[ai][1][m][0] + b_gb; f32x4 zc = acc[ai][1][m][1] + b_zc;
#pragma unroll
                    for (int j = 0; j < 4; ++j) zc[j] = zc[j] * sigm(zc[j]);
                    const f32x4 uu = ux * gc, gz = gb * zc;
                    u32x2 w0, w1; w0.x = cvt_pk_bf16(uu[0], uu[1]); w0.y = cvt_pk_bf16(uu[2], uu[3]); w1.x = cvt_pk_bf16(gz[0], gz[1]); w1.y = cvt_pk_bf16(gz[2], gz[3]);
                    *(u32x2*)(U + off) = w0; *(u32x2*)(GZ + off) = w1; }
        }
    }
};

struct EpiYA {
    static constexpr bool PERM = true, AFTER_DRAIN = false;
    const bf16_t* G; bf16_t* O;
    __device__ __forceinline__ void operator()(const f32x4 (&acc)[2][2][4][2], const Unit& u, int wr, int wc, int fr, int fq) const {
        const int row0 = u.pm * 256 + wr * 64 + fr, col0 = u.pn * 256 + wc * 32 + 8 * fq;
#pragma unroll
        for (int ai = 0; ai < 2; ++ai)
#pragma unroll
            for (int m = 0; m < 4; ++m) { const size_t off = (size_t)(row0 + ai * 128 + m * 16) * D + col0;
#pragma unroll
                for (int bj = 0; bj < 2; ++bj) { const u32x4 g = *(const u32x4*)(G + off + bj * 128); const f32x4 v0 = acc[ai][bj][m][0], v1 = acc[ai][bj][m][1];
                    u32x4 w; w.x = cvt_pk_bf16(v0[0] * bf_lo(g.x), v0[1] * bf_hi(g.x)); w.y = cvt_pk_bf16(v0[2] * bf_lo(g.y), v0[3] * bf_hi(g.y));
                    w.z = cvt_pk_bf16(v1[0] * bf_lo(g.z), v1[1] * bf_hi(g.z)); w.w = cvt_pk_bf16(v1[2] * bf_lo(g.w), v1[3] * bf_hi(g.w));
                    *(u32x4*)(O + off + bj * 128) = w; }
                asm volatile("" ::: "memory"); }
    }
};
struct EpiYB {
    static constexpr bool PERM = true, AFTER_DRAIN = false;
    const bf16_t* G; bf16_t* O;
    __device__ __forceinline__ void operator()(const f32x4 (&acc)[2][2][4][2], const Unit& u, int wr, int wc, int fr, int fq) const {
        const int row0 = u.pm * 256 + wr * 64 + fr, col0 = u.pn * 256 + wc * 32 + 8 * fq;
#pragma unroll
        for (int ai = 0; ai < 2; ++ai)
#pragma unroll
            for (int m = 0; m < 4; ++m) { const size_t off = (size_t)(row0 + ai * 128 + m * 16) * D + col0;
#pragma unroll
                for (int bj = 0; bj < 2; ++bj) { const u32x4 g = *(const u32x4*)(G + off + bj * 128); const u32x4 t = *(const u32x4*)(O + off + bj * 128);
                    const f32x4 v0 = acc[ai][bj][m][0], v1 = acc[ai][bj][m][1];
                    u32x4 w; w.x = cvt_pk_bf16(bf_lo(t.x) + v0[0] * bf_lo(g.x), bf_hi(t.x) + v0[1] * bf_hi(g.x)); w.y = cvt_pk_bf16(bf_lo(t.y) + v0[2] * bf_lo(g.y), bf_hi(t.y) + v0[3] * bf_hi(g.y));
                    w.z = cvt_pk_bf16(bf_lo(t.z) + v1[0] * bf_lo(g.z), bf_hi(t.z) + v1[1] * bf_hi(g.z)); w.w = cvt_pk_bf16(bf_lo(t.w) + v1[2] * bf_lo(g.w), bf_hi(t.w) + v1[3] * bf_hi(g.w));
                    *(u32x4*)(O + off + bj * 128) = w; }
                asm volatile("" ::: "memory"); }
    }
};
struct EpiOut {
    static constexpr bool PERM = true, AFTER_DRAIN = false;
    const float *x, *ada, *bo; float* out;
    __device__ __forceinline__ void operator()(const f32x4 (&acc)[2][2][4][2], const Unit& u, int wr, int wc, int fr, int fq) const {
        const int row0 = u.pm * 256 + wr * 64 + fr, col0 = u.pn * 256 + wc * 32 + 8 * fq;
        const float* gate = ada + (size_t)((u.pm * 256) >> 11) * 3072 + 2048;
        f32x4 gv[2][2], bv[2][2];
#pragma unroll
        for (int bj = 0; bj < 2; ++bj)
#pragma unroll
            for (int n = 0; n < 2; ++n) { gv[bj][n] = *(const f32x4*)(gate + col0 + bj * 128 + 4 * n); bv[bj][n] = *(const f32x4*)(bo + col0 + bj * 128 + 4 * n); }
#pragma unroll
        for (int ai = 0; ai < 2; ++ai)
#pragma unroll
            for (int m = 0; m < 4; ++m) { const size_t off = (size_t)(row0 + ai * 128 + m * 16) * D + col0;
#pragma unroll
                for (int bj = 0; bj < 2; ++bj)
#pragma unroll
                    for (int n = 0; n < 2; ++n) { const f32x4 xv = *(const f32x4*)(x + off + bj * 128 + 4 * n);
                        *(f32x4*)(out + off + bj * 128 + 4 * n) = xv * ALPHA + gv[bj][n] * (acc[ai][bj][m][n] + bv[bj][n]); }
                asm volatile("" ::: "memory"); }
    }
};

constexpr int KS_PITCH = 144, VT_OFF = 256 * KS_PITCH, VT_PITCH = 528;
__device__ __forceinline__ void attn_phase(const Params& p, LAS unsigned char* lds, int tid, int G, int bid) {
    const int w = __builtin_amdgcn_readfirstlane(tid >> 6), lane = tid & 63, fr = lane & 15, quad = lane >> 4;
    const bf16_t* QKV = (const bf16_t*)(p.ws + WS_QKV);
    bf16_t* OG = (bf16_t*)((unsigned char*)p.out + DO_OG);
    float* LSE = (float*)((unsigned char*)p.out + DO_LSE);
    for (int uid = bid; uid < 3072; uid += G) {
        const int b = uid / 192; int rem = uid - b * 192; const int g = rem >> 6; rem &= 63; const int hh = rem >> 4, blk = rem & 15;
        const int dsh = 2 * g, d = 1 << dsh, r = blk & (d - 1), nb = blk >> dsh;
        const int head = g * 4 + hh;
        const bf16_t* base = QKV + (size_t)b * SEQ * QKVW + head * 64;
#pragma unroll
        for (int i = 0; i < 4; ++i) { const int c = tid + NTHREADS * i, row = c >> 3, part = c & 7, sub = nb * 128 + row - 128;
            u32x4 v = {0u, 0u, 0u, 0u}; if (sub >= 0) v = *(const u32x4*)(base + (size_t)((sub << dsh) + r) * QKVW + 768 + part * 8);
            *(LAS u32x4*)(lds + row * KS_PITCH + part * 16) = v; }
#pragma unroll
        for (int i = 0; i < 4; ++i) { const int c = tid + NTHREADS * i, part = c >> 8, row = c & 255, sub = nb * 128 + row - 128;
            u32x4 v = {0u, 0u, 0u, 0u}; if (sub >= 0) v = *(const u32x4*)(base + (size_t)((sub << dsh) + r) * QKVW + 1536 + part * 8);
            LAS bf16_t* vt = (LAS bf16_t*)(lds + VT_OFF + (part * 8) * VT_PITCH) + row;
            vt[0 * (VT_PITCH / 2)] = (bf16_t)(v.x & 0xffffu); vt[1 * (VT_PITCH / 2)] = (bf16_t)(v.x >> 16); vt[2 * (VT_PITCH / 2)] = (bf16_t)(v.y & 0xffffu); vt[3 * (VT_PITCH / 2)] = (bf16_t)(v.y >> 16);
            vt[4 * (VT_PITCH / 2)] = (bf16_t)(v.z & 0xffffu); vt[5 * (VT_PITCH / 2)] = (bf16_t)(v.z >> 16); vt[6 * (VT_PITCH / 2)] = (bf16_t)(v.w & 0xffffu); vt[7 * (VT_PITCH / 2)] = (bf16_t)(v.w >> 16); }
        const int qi = 16 * w + fr, tq = ((nb * 128 + qi) << dsh) + r;
        const bf16_t* qp = base + (size_t)tq * QKVW + quad * 8;
        const bf16x8 q0 = *(const bf16x8*)qp, q1 = *(const bf16x8*)(qp + 32);
        __syncthreads();
        const int tstart = w & ~1;
        f32x4 s[10];
#pragma unroll
        for (int tt = 0; tt < 10; ++tt) { const LAS unsigned char* kp = lds + (16 * (tstart + tt) + fr) * KS_PITCH + quad * 16;
            const bf16x8 k0 = *(const LAS bf16x8*)kp, k1 = *(const LAS bf16x8*)(kp + 64);
            f32x4 a = {0.f, 0.f, 0.f, 0.f};
            a = __builtin_amdgcn_mfma_f32_16x16x32_bf16(k0, q0, a, 0, 0, 0);
            s[tt] = __builtin_amdgcn_mfma_f32_16x16x32_bf16(k1, q1, a, 0, 0, 0); }
        const float sl2 = __builtin_amdgcn_exp2f(-8.0f * (float)(head + 1) / 12.0f) * (float)d * LOG2E;
        float mx = -INFINITY;
#pragma unroll
        for (int tt = 0; tt < 10; ++tt)
#pragma unroll
            for (int j = 0; j < 4; ++j) { const int kj = 16 * (tstart + tt) + 4 * quad + j, delta = qi + 128 - kj;
                const bool valid = (delta >= 0) && (delta <= 128) && (nb > 0 || kj >= 128);
                const float v = valid ? s[tt][j] - sl2 * (float)delta : -INFINITY; s[tt][j] = v; mx = fmaxf(mx, v); }
        mx = fmaxf(mx, __shfl_xor(mx, 16)); mx = fmaxf(mx, __shfl_xor(mx, 32));
        float den = 0.f;
#pragma unroll
        for (int tt = 0; tt < 10; ++tt)
#pragma unroll
            for (int j = 0; j < 4; ++j) { const float e = __builtin_amdgcn_exp2f(s[tt][j] - mx); s[tt][j] = e; den += e; }
        den += __shfl_xor(den, 16); den += __shfl_xor(den, 32);
        f32x4 o[4];
#pragma unroll
        for (int dt = 0; dt < 4; ++dt) o[dt] = (f32x4){0.f, 0.f, 0.f, 0.f};
#pragma unroll
        for (int c = 0; c < 5; ++c) {
            union { u32x4 u; bf16x8 h; } pf;
            pf.u.x = cvt_pk_bf16(s[2 * c][0], s[2 * c][1]); pf.u.y = cvt_pk_bf16(s[2 * c][2], s[2 * c][3]);
            pf.u.z = cvt_pk_bf16(s[2 * c + 1][0], s[2 * c + 1][1]); pf.u.w = cvt_pk_bf16(s[2 * c + 1][2], s[2 * c + 1][3]);
#pragma unroll
            for (int dt = 0; dt < 4; ++dt) { const LAS unsigned char* vp = lds + VT_OFF + (16 * dt + fr) * VT_PITCH + (16 * (tstart + 2 * c) + 4 * quad) * 2;
                union { u32x4 u; bf16x8 h; } vf; const u32x2 lo = *(const LAS u32x2*)vp, hi = *(const LAS u32x2*)(vp + 32);
                vf.u.x = lo.x; vf.u.y = lo.y; vf.u.z = hi.x; vf.u.w = hi.y;
                o[dt] = __builtin_amdgcn_mfma_f32_16x16x32_bf16(vf.h, pf.h, o[dt], 0, 0, 0); }
        }
        const float inv = 1.0f / den;
        bf16_t* op = OG + ((size_t)g * M + (size_t)b * SEQ + tq) * AOW + hh * 64 + 4 * quad;
#pragma unroll
        for (int dt = 0; dt < 4; ++dt) { u32x2 wv; wv.x = cvt_pk_bf16(o[dt][0] * inv, o[dt][1] * inv); wv.y = cvt_pk_bf16(o[dt][2] * inv, o[dt][3] * inv); *(u32x2*)(op + 16 * dt) = wv; }
        if (quad == 0) LSE[(size_t)uid * 128 + qi] = (mx + __builtin_amdgcn_logf(den)) * LN2F;
        __syncthreads();
    }
}

__device__ __forceinline__ void ew_phase(const Params& p, int gw, int NGW, int lane) {
    const bf16_t* OG = (const bf16_t*)((const unsigned char*)p.out + DO_OG);
    const bf16_t* ZA = (const bf16_t*)((const unsigned char*)p.out + DO_ZA);
    const float* LSE = (const float*)((const unsigned char*)p.out + DO_LSE);
    bf16_t* OZ = (bf16_t*)(p.ws + WS_QKV);
    for (int it = gw; it < M / 2; it += NGW) {
        const int m = it * 2 + (lane >> 5), ci = (lane & 31) * 8, hh = ci >> 6;
        const int bb = m >> 11, t = m & (SEQ - 1), ub = bb * 192 + hh * 16;
        const float l0 = LSE[(size_t)(ub + (t >> 7)) * 128 + (t & 127)];
        const float l1 = LSE[(size_t)(ub + 64 + (t & 3) + ((t >> 9) << 2)) * 128 + ((t >> 2) & 127)];
        const float l2 = LSE[(size_t)(ub + 128 + (t & 15)) * 128 + (t >> 4)];
        const float mx = fmaxf(l0, fmaxf(l1, l2));
        float e0 = __builtin_amdgcn_exp2f((l0 - mx) * LOG2E), e1 = __builtin_amdgcn_exp2f((l1 - mx) * LOG2E), e2 = __builtin_amdgcn_exp2f((l2 - mx) * LOG2E);
        const float inv = 1.0f / (e0 + e1 + e2); e0 *= inv; e1 *= inv; e2 *= inv;
        const size_t off = (size_t)m * AOW + ci;
        const u32x4 a0 = *(const u32x4*)(OG + off), a1 = *(const u32x4*)(OG + (size_t)M * AOW + off), a2 = *(const u32x4*)(OG + (size_t)2 * M * AOW + off), z = *(const u32x4*)(ZA + off);
        u32x4 o;
#pragma unroll
        for (int j = 0; j < 4; ++j) { const float lo = (e0 * bf_lo(a0[j]) + e1 * bf_lo(a1[j]) + e2 * bf_lo(a2[j])) * bf_lo(z[j]), hi = (e0 * bf_hi(a0[j]) + e1 * bf_hi(a1[j]) + e2 * bf_hi(a2[j])) * bf_hi(z[j]); o[j] = cvt_pk_bf16(lo, hi); }
        *(u32x4*)(OZ + off) = o;
    }
    const bf16_t* U = (const bf16_t*)(p.ws + WS_U); const bf16_t* GZ = (const bf16_t*)(p.ws + WS_GZ); bf16_t* CV = (bf16_t*)(p.ws + WS_H);
    for (int it = gw; it < (M / 16) * 2; it += NGW) {
        const int half = it & 1, m0 = (it >> 1) * 16, ch = half * 512 + lane * 8, t0 = m0 & (SEQ - 1);
        float c0[8], c1[8], c2[8];
#pragma unroll
        for (int j = 0; j < 8; ++j) { c0[j] = p.conv_w[ch + j]; c1[j] = p.conv_w[D + ch + j]; c2[j] = p.conv_w[2 * D + ch + j]; }
        u32x4 um2 = {0u, 0u, 0u, 0u}, um1 = um2;
        if (t0 >= 2) { um2 = *(const u32x4*)(U + (size_t)(m0 - 2) * D + ch); um1 = *(const u32x4*)(U + (size_t)(m0 - 1) * D + ch); }
#pragma unroll 4
        for (int i = 0; i < 16; ++i) { const size_t off = (size_t)(m0 + i) * D + ch; const u32x4 u0 = *(const u32x4*)(U + off), gz = *(const u32x4*)(GZ + off);
            u32x4 o;
#pragma unroll
            for (int j = 0; j < 4; ++j) { const float lo = bf_lo(gz[j]) * (c0[2 * j] * bf_lo(um2[j]) + c1[2 * j] * bf_lo(um1[j]) + c2[2 * j] * bf_lo(u0[j]));
                const float hi = bf_hi(gz[j]) * (c0[2 * j + 1] * bf_hi(um2[j]) + c1[2 * j + 1] * bf_hi(um1[j]) + c2[2 * j + 1] * bf_hi(u0[j])); o[j] = cvt_pk_bf16(lo, hi); }
            *(u32x4*)(CV + off) = o; um2 = um1; um1 = u0; }
    }
}

#define GSYNC() do { ++seam; asm volatile("s_waitcnt vmcnt(0) lgkmcnt(0)" ::: "memory"); __syncthreads(); \
    if (tid == 0) { __builtin_amdgcn_fence(__ATOMIC_RELEASE, "agent"); asm volatile("s_waitcnt vmcnt(0)" ::: "memory"); \
        __hip_atomic_fetch_add(barw, 1u, __ATOMIC_RELAXED, __HIP_MEMORY_SCOPE_AGENT); \
        while (__hip_atomic_load(barw, __ATOMIC_RELAXED, __HIP_MEMORY_SCOPE_AGENT) < (unsigned)(seam * G)) __builtin_amdgcn_s_sleep(2); } \
    __syncthreads(); __builtin_amdgcn_fence(__ATOMIC_ACQUIRE, "agent"); asm volatile("s_waitcnt vmcnt(0)" ::: "memory"); } while (0)
__global__ void __launch_bounds__(NTHREADS, 2) fwd(Params p) {
    extern __shared__ __attribute__((aligned(16))) unsigned char lds_raw[];
    LAS unsigned char* lds = (LAS unsigned char*)lds_raw;
    cg::grid_group grid = cg::this_grid();
    const int tid = threadIdx.x, lane = tid & 63, wave = __builtin_amdgcn_readfirstlane(tid >> 6);
    const int G = gridDim.x, bid = blockIdx.x;
    const int gw = bid * NWAVES + wave, NGW = G * NWAVES;
    unsigned* barw = (unsigned*)(p.ws + WS_BAR); int seam = 0;
    grid.sync();
    float* ADA = (float*)(p.ws + WS_ADA);
    bf16_t* WIN = (bf16_t*)(p.ws + WS_WIN); bf16_t* WPA = (bf16_t*)(p.ws + WS_WPA); bf16_t* WPB = (bf16_t*)(p.ws + WS_WPB); bf16_t* WOUT = (bf16_t*)(p.ws + WS_WOUT);
    bf16_t* H = (bf16_t*)(p.ws + WS_H);

    if (bid < 48) ada_block(p, lds, bid, tid);
    {
        LAS float* scr = (LAS float*)(lds + wave * 16384);
        constexpr int I_IN = (D / 64) * (DIN / 32), I_PA = (AOW / 64) * (D / 32), I_PB = (D / 64) * (D / 32), I_OUT = I_PB;
        for (int it = gw; it < I_IN + I_PA + I_PB + I_OUT; it += NGW) {
            int r = it;
            if (r < I_IN) { transpose_item<true>(p.w_in, D, DIN, WIN, scr, r, lane); continue; } r -= I_IN;
            if (r < I_PA) { transpose_item<false>(p.w_pa, AOW, D, WPA, scr, r, lane); continue; } r -= I_PA;
            if (r < I_PB) { transpose_item<false>(p.w_pb, D, D, WPB, scr, r, lane); continue; } r -= I_PB;
            transpose_item<false>(p.w_out, D, D, WOUT, scr, r, lane);
        }
    }
    GSYNC();

    for (int m = gw; m < M; m += NGW) {
        const float* ad = ADA + (size_t)(m >> 11) * 3072;
        const f32x4* xr = (const f32x4*)(p.x + (size_t)m * D) + lane;
        unsigned long long* o8 = (unsigned long long*)(H + (size_t)m * D) + lane;
#pragma unroll
        for (int j = 0; j < 4; ++j) { const f32x4 v = xr[64 * j]; const f32x4 sh = *((const f32x4*)ad + lane + 64 * j), sc = *((const f32x4*)(ad + 1024) + lane + 64 * j);
            const f32x4 h = v * (sc + 1.0f) + sh;
            o8[64 * j] = (unsigned long long)cvt_pk_bf16(h[0], h[1]) | ((unsigned long long)cvt_pk_bf16(h[2], h[3]) << 32); }
    }
    GSYNC();

    {
        pg8::Gemm g{H, WIN, M, DIN, D}; pg8::StaticOrder S; S.init(M, DIN, G, bid);
        EpiIn E{p.b_in, (bf16_t*)(p.ws + WS_QKV), (bf16_t*)((unsigned char*)p.out + DO_ZA), (bf16_t*)(p.ws + WS_U), (bf16_t*)(p.ws + WS_GZ), (bf16_t*)(p.ws + WS_GA), (bf16_t*)(p.ws + WS_GB)};
        pg8::gemm_phase<EpiIn, pg8::StaticOrder, true, true>(lds, g, S, E);
    }
    GSYNC();

    attn_phase(p, lds, tid, G, bid);
    GSYNC();

    ew_phase(p, gw, NGW, lane);
    GSYNC();

    {
        bf16_t* MERGED = (bf16_t*)(p.ws + WS_U);
        pg8::StaticOrder S; S.init(M, D, G, bid);
        int kpa = AOW; asm volatile("" : "+s"(kpa));
        { pg8::Gemm g{(const bf16_t*)(p.ws + WS_QKV), WPA, M, D, kpa}; EpiYA E{(const bf16_t*)(p.ws + WS_GA), MERGED};
          pg8::gemm_phase<EpiYA, pg8::StaticOrder, true, true>(lds, g, S, E); }
        { pg8::Gemm g{(const bf16_t*)(p.ws + WS_H), WPB, M, D, D}; EpiYB E{(const bf16_t*)(p.ws + WS_GB), MERGED};
          pg8::gemm_phase<EpiYB, pg8::StaticOrder, true, true>(lds, g, S, E); }
    }
    GSYNC();

    {
        pg8::Gemm g{(const bf16_t*)(p.ws + WS_U), WOUT, M, D, D}; pg8::StaticOrder S; S.init(M, D, G, bid);
        EpiOut E{p.x, ADA, p.b_out, p.out};
        pg8::gemm_phase<EpiOut, pg8::StaticOrder, true, true>(lds, g, S, E);
    }
    GSYNC();

    for (int m = gw; m < M; m += NGW) {
        f32x4* xr = (f32x4*)(p.out + (size_t)m * D) + lane;
        f32x4 v[4]; float s = 0.f;
#pragma unroll
        for (int j = 0; j < 4; ++j) { v[j] = xr[64 * j]; s += (v[j][0] + v[j][1]) + (v[j][2] + v[j][3]); }
        const float mean = wave_sum(s) * (1.f / D); float s2 = 0.f;
#pragma unroll
        for (int j = 0; j < 4; ++j) { v[j] = v[j] - mean; s2 += (v[j][0] * v[j][0] + v[j][1] * v[j][1]) + (v[j][2] * v[j][2] + v[j][3] * v[j][3]); }
        const float rstd = 1.f / sqrtf(wave_sum(s2) * (1.f / D) + LN_EPS);
#pragma unroll
        for (int j = 0; j < 4; ++j) { const f32x4 gg = *((const f32x4*)p.ln_g + lane + 64 * j), bb = *((const f32x4*)p.ln_b + lane + 64 * j); xr[64 * j] = v[j] * rstd * gg + bb; }
    }
}
}

extern "C" void kernel_launch(void* const* d_in, const int* in_sizes, int n_in, void* d_out, int out_size, void* d_ws, size_t ws_size, hipStream_t stream) {
    static int grid = 0;
    if (grid == 0) {
        if (n_in != 13 || out_size != mk::M * mk::D || ws_size < mk::WS_END) { fprintf(stderr, "kernel_launch: unexpected shapes (n_in %d out %d ws %zu)\n", n_in, out_size, ws_size); grid = -1; return; }
        int dev = 0, cus = 0, per_cu = 0;
        hipGetDevice(&dev); hipDeviceGetAttribute(&cus, hipDeviceAttributeMultiprocessorCount, dev);
        hipFuncSetAttribute((const void*)mk::fwd, hipFuncAttributeMaxDynamicSharedMemorySize, mk::LDS_BYTES);
        hipOccupancyMaxActiveBlocksPerMultiprocessor(&per_cu, (const void*)mk::fwd, mk::NTHREADS, mk::LDS_BYTES);
        if (per_cu < 1) { fprintf(stderr, "kernel_launch: occupancy query says %d blocks per CU\n", per_cu); grid = -1; return; }
        grid = cus;
    }
    if (grid < 0) return;
    mk::Params p{};
    p.x = (const float*)d_in[0]; p.c = (const float*)d_in[1]; p.w_ada = (const float*)d_in[2]; p.b_ada = (const float*)d_in[3]; p.w_in = (const float*)d_in[4]; p.b_in = (const float*)d_in[5];
    p.conv_w = (const float*)d_in[6]; p.w_pa = (const float*)d_in[7]; p.w_pb = (const float*)d_in[8]; p.w_out = (const float*)d_in[9]; p.b_out = (const float*)d_in[10];
    p.ln_g = (const float*)d_in[11]; p.ln_b = (const float*)d_in[12]; p.out = (float*)d_out; p.ws = (unsigned char*)d_ws;
    (void)hipMemsetAsync((unsigned char*)d_ws + mk::WS_BAR, 0, 256, stream);
    void* args[] = {&p};
    hipError_t e = hipLaunchCooperativeKernel((const void*)mk::fwd, dim3(grid), dim3(mk::NTHREADS), args, mk::LDS_BYTES, stream);
    if (e != hipSuccess) fprintf(stderr, "cooperative launch failed: %s (grid %d)\n", hipGetErrorString(e), grid);
}
```
